# Optimizing an MI355X kernel written in HIP

```python
import jax, jax.numpy as jnp
from jax import lax
import numpy as np

D_MODEL = 1024
BATCH = 4
SEQ = 4096
DEPTH = 2

N_MIXERS = 2
N_MLSTM_LAYERS = (DEPTH + 1) // 2
N_RWKV_LAYERS = DEPTH // 2
DN_ALPHA = (2.0 * DEPTH) ** 0.25
DN_BETA = (8.0 * DEPTH) ** -0.25
LN_EPS = 1e-5
D_FF = 4 * D_MODEL

M_HEADS = 4
M_DV = D_MODEL // M_HEADS
M_DK = M_DV // 2
M_CHUNK = 64
M_CONV = 4
M_GATE_CAP = 15.0
M_QK = 2 * M_HEADS * M_DK
M_PROJ = M_QK + 2 * M_HEADS * M_DV + 2 * M_HEADS

R_N = 64
R_HEADS = D_MODEL // R_N
R_LW = D_MODEL // 16
R_LA = D_MODEL // 16
R_LG = D_MODEL // 8
R_PROJ = 3 * D_MODEL + R_LW + R_LA + R_LG
R_GN_EPS = 64e-5

kernel_name = 'hybrid_mlstm_rwkv7_deepnorm'


def layer_norm(x, g, b):
    xf = x.astype(jnp.float32)
    mu = jnp.mean(xf, -1, keepdims=True)
    var = jnp.mean(jnp.square(xf - mu), -1, keepdims=True)
    return ((xf - mu) * lax.rsqrt(var + LN_EPS) * g + b).astype(x.dtype)


def causal_depthwise_conv(x, w, b):
    k = w.shape[0]
    y = lax.conv_general_dilated(x, w[:, None, :].astype(x.dtype), window_strides=(1,),
                                 padding=[(k - 1, 0)], dimension_numbers=('NWC', 'WIO', 'NWC'),
                                 feature_group_count=x.shape[-1])
    return y + b


def token_shift(x):
    return jnp.pad(x, ((0, 0), (1, 0), (0, 0)))[:, :-1]


def soft_cap(x, cap):
    return cap * jnp.tanh(x / cap)


def mlstm_chunkwise(q, k, v, log_i, log_f):
    bsz, seq = q.shape[0], q.shape[1]
    nc = seq // M_CHUNK

    def chunks(t):
        return t.reshape(bsz, nc, M_CHUNK, M_HEADS, -1).transpose(1, 0, 3, 2, 4)

    def gchunks(t):
        return t.reshape(bsz, nc, M_CHUNK, M_HEADS).transpose(1, 0, 3, 2)

    causal = jnp.tril(jnp.ones((M_CHUNK, M_CHUNK), dtype=bool))

    def step(carry, inp):
        c_prev, n_prev, m_prev = carry
        qc, kc, vc, ic, fc = inp
        bcum = jnp.cumsum(fc, axis=-1)
        log_d = bcum[..., :, None] - bcum[..., None, :] + ic[..., None, :]
        log_d = jnp.where(causal, log_d, -jnp.inf)
        log_inter = bcum + m_prev[..., None]
        m_row = jnp.maximum(jnp.max(log_d, -1), log_inter)
        d_mat = jnp.exp(log_d - m_row[..., None])
        inter = jnp.exp(log_inter - m_row)
        s = jnp.einsum('bhld,bhsd->bhls', qc, kc) * d_mat
        num = jnp.einsum('bhls,bhse->bhle', s, vc) + inter[..., None] * jnp.einsum('bhld,bhde->bhle', qc, c_prev)
        den = jnp.sum(s, -1) + inter * jnp.einsum('bhld,bhd->bhl', qc, n_prev)
        hc = num / jnp.maximum(jnp.abs(den), jnp.exp(-m_row))[..., None]
        b_last = bcum[..., -1]
        log_w = b_last[..., None] - bcum + ic
        m_new = jnp.maximum(b_last + m_prev, jnp.max(log_w, -1))
        decay = jnp.exp(b_last + m_prev - m_new)
        wk = jnp.exp(log_w - m_new[..., None])
        c_new = decay[..., None, None] * c_prev + jnp.einsum('bhl,bhld,bhle->bhde', wk, kc, vc)
        n_new = decay[..., None] * n_prev + jnp.einsum('bhl,bhld->bhd', wk, kc)
        return (c_new, n_new, m_new), hc

    init = (jnp.zeros((bsz, M_HEADS, M_DK, M_DV), jnp.float32),
            jnp.zeros((bsz, M_HEADS, M_DK), jnp.float32),
            jnp.zeros((bsz, M_HEADS), jnp.float32))
    _, h = lax.scan(step, init, (chunks(q), chunks(k), chunks(v), gchunks(log_i), gchunks(log_f)))
    return h.transpose(1, 0, 3, 2, 4).reshape(bsz, seq, M_HEADS, M_DV)


def mlstm_mixer(x, w_in, b_i, b_f, conv_w, conv_b, norm_g, w_out):
    bsz, seq, _ = x.shape
    f32 = jnp.float32
    proj = x @ w_in
    qk = jax.nn.silu(causal_depthwise_conv(proj[..., :M_QK], conv_w, conv_b)).astype(f32)
    q = qk[..., :M_QK // 2].reshape(bsz, seq, M_HEADS, M_DK) * (M_DK ** -0.5)
    k = qk[..., M_QK // 2:].reshape(bsz, seq, M_HEADS, M_DK)
    o0 = M_QK
    o1 = o0 + M_HEADS * M_DV
    o2 = o1 + M_HEADS * M_DV
    v = proj[..., o0:o1].astype(f32).reshape(bsz, seq, M_HEADS, M_DV)
    o_gate = jax.nn.sigmoid(proj[..., o1:o2].astype(f32))
    gates = proj[..., o2:].astype(f32)
    log_i = soft_cap(gates[..., :M_HEADS] + b_i, M_GATE_CAP)
    log_f = jax.nn.log_sigmoid(soft_cap(gates[..., M_HEADS:] + b_f, M_GATE_CAP))
    h = mlstm_chunkwise(q, k, v, log_i, log_f)
    h = h * lax.rsqrt(jnp.mean(jnp.square(h), -1, keepdims=True) + 1e-6)
    h = h.reshape(bsz, seq, M_HEADS * M_DV) * norm_g * o_gate
    return h.astype(x.dtype) @ w_out


def wkv7_scan(r, w, k, v, a, b):
    bsz = r.shape[0]

    def step(state, inp):
        rt, wt, kt, vt, at, bt = inp
        sa = jnp.einsum('bhvk,bhk->bhv', state, at)
        state = state * wt[:, :, None, :] + sa[..., None] * bt[:, :, None, :] + vt[..., None] * kt[:, :, None, :]
        return state, jnp.einsum('bhvk,bhk->bhv', state, rt)

    init = jnp.zeros((bsz, R_HEADS, R_N, R_N), jnp.float32)
    xs = (jnp.swapaxes(r, 0, 1), jnp.swapaxes(w, 0, 1), jnp.swapaxes(k, 0, 1),
          jnp.swapaxes(v, 0, 1), jnp.swapaxes(a, 0, 1), jnp.swapaxes(b, 0, 1))
    _, y = lax.scan(step, init, xs)
    return jnp.swapaxes(y, 0, 1)


def rwkv7_mixer(x, w_in, mu, w0, w2, a0, a2, g2, k_k, k_a, r_k, gn_g, gn_b, w_out):
    bsz, seq, d = x.shape
    proj = x @ w_in
    proj = (proj + mu * (token_shift(proj) - proj)).astype(jnp.float32)
    r = proj[..., :d]
    k = proj[..., d:2 * d]
    v = proj[..., 2 * d:3 * d]
    xw = proj[..., 3 * d:3 * d + R_LW]
    xa = proj[..., 3 * d + R_LW:3 * d + R_LW + R_LA]
    xg = proj[..., 3 * d + R_LW + R_LA:]
    log_w = -jax.nn.softplus(-(w0 + jnp.tanh(xw) @ w2)) - 0.5
    decay = jnp.exp(-jnp.exp(log_w))
    a = jax.nn.sigmoid(a0 + xa @ a2)
    g = jax.nn.sigmoid(xg) @ g2
    kk = (k * k_k).reshape(bsz, seq, R_HEADS, R_N)
    kk = kk / jnp.maximum(jnp.sqrt(jnp.sum(jnp.square(kk), -1, keepdims=True)), 1e-12)
    k = k * (1.0 + (a - 1.0) * k_a)
    r_h = r.reshape(bsz, seq, R_HEADS, R_N)
    k_h = k.reshape(bsz, seq, R_HEADS, R_N)
    v_h = v.reshape(bsz, seq, R_HEADS, R_N)
    a_h = a.reshape(bsz, seq, R_HEADS, R_N)
    w_h = decay.reshape(bsz, seq, R_HEADS, R_N)
    y = wkv7_scan(r_h, w_h, k_h, v_h, -kk, kk * a_h)
    y_mu = jnp.mean(y, -1, keepdims=True)
    y_var = jnp.mean(jnp.square(y - y_mu), -1, keepdims=True)
    y = ((y - y_mu) * lax.rsqrt(y_var + R_GN_EPS)).reshape(bsz, seq, d) * gn_g + gn_b
    bonus = jnp.sum(r_h * k_h * r_k, -1, keepdims=True) * v_h
    y = (y + bonus.reshape(bsz, seq, d)) * g
    return y.astype(x.dtype) @ w_out


def squared_relu_mlp(x, w1, w2):
    return jnp.square(jax.nn.relu(x @ w1)) @ w2


def setup_inputs(seed: int = 0) -> dict:
    key = jax.random.key(seed)
    ks = jax.random.split(key, 28)
    f32 = jnp.float32
    nm, nr, d = N_MLSTM_LAYERS, N_RWKV_LAYERS, D_MODEL

    def normal(k, shape, s):
        return s * jax.random.normal(k, shape, f32)

    return {
        'x': normal(ks[0], (BATCH, SEQ, d), 1.0),
        'mlstm_w_in': normal(ks[1], (nm, d, M_PROJ), d ** -0.5),
        'mlstm_b_i': normal(ks[2], (nm, M_HEADS), 0.1),
        'mlstm_b_f': jnp.linspace(3.0, 6.0, M_HEADS, dtype=f32) + normal(ks[3], (nm, M_HEADS), 0.1),
        'mlstm_conv_w': normal(ks[4], (nm, M_CONV, M_QK), M_CONV ** -0.5),
        'mlstm_conv_b': normal(ks[5], (nm, M_QK), 0.01),
        'mlstm_norm_g': 1.0 + normal(ks[6], (nm, M_HEADS * M_DV), 0.01),
        'mlstm_w_out': normal(ks[7], (nm, M_HEADS * M_DV, d), DN_BETA * (M_HEADS * M_DV) ** -0.5),
        'rwkv_w_in': normal(ks[8], (nr, d, R_PROJ), d ** -0.5),
        'rwkv_mu': jax.random.uniform(ks[9], (nr, R_PROJ), f32),
        'rwkv_w0': jnp.linspace(-6.5, -1.5, d, dtype=f32) + normal(ks[10], (nr, d), 0.1),
        'rwkv_w2': normal(ks[11], (nr, R_LW, d), 0.5 * R_LW ** -0.5),
        'rwkv_a0': normal(ks[12], (nr, d), 0.1),
        'rwkv_a2': normal(ks[13], (nr, R_LA, d), 0.5 * R_LA ** -0.5),
        'rwkv_g2': normal(ks[14], (nr, R_LG, d), R_LG ** -0.5),
        'rwkv_k_k': 0.85 + normal(ks[15], (nr, d), 0.02),
        'rwkv_k_a': 1.0 + normal(ks[16], (nr, d), 0.02),
        'rwkv_r_k': normal(ks[17], (nr, R_HEADS, R_N), 0.1),
        'rwkv_gn_g': 1.0 + normal(ks[18], (nr, d), 0.01),
        'rwkv_gn_b': normal(ks[19], (nr, d), 0.01),
        'rwkv_w_out': normal(ks[20], (nr, d, d), DN_BETA * d ** -0.5),
        'ln_mix_g': 1.0 + normal(ks[21], (DEPTH, d), 0.01),
        'ln_mix_b': normal(ks[22], (DEPTH, d), 0.01),
        'mlp_w1': normal(ks[23], (DEPTH, d, D_FF), d ** -0.5),
        'mlp_w2': normal(ks[24], (DEPTH, D_FF, d), DN_BETA * D_FF ** -0.5),
        'ln_ffn_g': 1.0 + normal(ks[25], (DEPTH, d), 0.01),
        'ln_ffn_b': normal(ks[26], (DEPTH, d), 0.01),
    }


def reference(x, mlstm_w_in, mlstm_b_i, mlstm_b_f, mlstm_conv_w, mlstm_conv_b, mlstm_norm_g, mlstm_w_out,
              rwkv_w_in, rwkv_mu, rwkv_w0, rwkv_w2, rwkv_a0, rwkv_a2, rwkv_g2, rwkv_k_k, rwkv_k_a, rwkv_r_k,
              rwkv_gn_g, rwkv_gn_b, rwkv_w_out, ln_mix_g, ln_mix_b, mlp_w1, mlp_w2, ln_ffn_g, ln_ffn_b):
    for layer in range(DEPTH):
        j = layer // N_MIXERS
        if layer % N_MIXERS == 0:
            mix = mlstm_mixer(x, mlstm_w_in[j], mlstm_b_i[j], mlstm_b_f[j], mlstm_conv_w[j], mlstm_conv_b[j],
                              mlstm_norm_g[j], mlstm_w_out[j])
        else:
            mix = rwkv7_mixer(x, rwkv_w_in[j], rwkv_mu[j], rwkv_w0[j], rwkv_w2[j], rwkv_a0[j], rwkv_a2[j],
                              rwkv_g2[j], rwkv_k_k[j], rwkv_k_a[j], rwkv_r_k[j], rwkv_gn_g[j], rwkv_gn_b[j],
                              rwkv_w_out[j])
        x = layer_norm(DN_ALPHA * x + mix, ln_mix_g[layer], ln_mix_b[layer])
        x = layer_norm(DN_ALPHA * x + squared_relu_mlp(x, mlp_w1[layer], mlp_w2[layer]),
                       ln_ffn_g[layer], ln_ffn_b[layer])
    return x
```

```cpp
#include <hip/hip_runtime.h>
#include <hip/hip_cooperative_groups.h>
#include <cstdio>
#include <cstdint>
namespace cg = cooperative_groups;

#ifndef N_LAUNCH_MODE
#define N_LAUNCH_MODE 0
#endif

typedef unsigned short bf16_t;
typedef short bf16x8 __attribute__((ext_vector_type(8)));
typedef float f32x4 __attribute__((ext_vector_type(4)));
typedef float f32x2 __attribute__((ext_vector_type(2)));
typedef unsigned u32x4 __attribute__((ext_vector_type(4)));
typedef unsigned u32x2 __attribute__((ext_vector_type(2)));

constexpr int NT = 512, NWAVES = 8;
constexpr int T_ = 16384, D_ = 1024, SEQ_ = 4096, FF_ = 4096;
constexpr int MPROJ = 3080, RPROJ = 3328;
constexpr float DN_ALPHA = 1.4142135623730951f;
constexpr float LN_EPS = 1e-5f;
constexpr int LDS_BYTES = 147456;

constexpr size_t MiB = 1u << 20, KiB = 1u << 10;
constexpr size_t WS_CTL = 0, CTL_BYTES = 128 * KiB;
constexpr size_t WS_LI = 256 * KiB, WS_LF = 512 * KiB, WS_BC = 768 * KiB, WS_GG = 1024 * KiB;
constexpr size_t WS_XBUF = 2 * MiB;
constexpr size_t WS_WROUT = 4 * MiB, WS_W1_1 = 6 * MiB, WS_W2_1 = 14 * MiB;
constexpr size_t WS_WRIN = 22 * MiB, WS_WLOW = 28 * MiB + 512 * KiB;
constexpr size_t WS_WMIN = 30 * MiB, WS_WMOUT = 36 * MiB, WS_W1_0 = 38 * MiB, WS_W2_0 = 46 * MiB;
constexpr size_t WS_XB = 54 * MiB;
constexpr size_t WS_HRAW = 54 * MiB;
constexpr size_t WS_QKRAW = 118 * MiB, WS_V0 = 150 * MiB, WS_O0 = 182 * MiB, WS_QKC = 214 * MiB;
constexpr size_t WS_HN = 118 * MiB;
constexpr size_t WS_HB = 118 * MiB;
constexpr size_t WS_TMP_S3 = 150 * MiB, WS_TMP_S5 = 54 * MiB, WS_TMP_S8 = 126 * MiB, WS_TMP_S10 = 30 * MiB;
constexpr size_t WS_PR = 126 * MiB;
constexpr size_t WS_LOWA = 230 * MiB;
constexpr size_t WS_W1M = 30 * MiB, WS_A = 62 * MiB, WS_G = 94 * MiB;
constexpr size_t WS_Y_B0 = 22 * MiB, WS_Y_B123 = 230 * MiB;
constexpr size_t WS_YB = 30 * MiB;
constexpr size_t WS_X3B = 62 * MiB;
constexpr size_t WS_END = 256 * MiB;

struct Params { const float* in[27]; float* out; unsigned char* ws; int ph_lo, ph_hi; };

__device__ __forceinline__ unsigned f2bf(float f) { unsigned u = __float_as_uint(f); return (u + 0x7fffu + ((u >> 16) & 1u)) >> 16; }
__device__ __forceinline__ unsigned pk2(float lo, float hi) { return f2bf(lo) | (f2bf(hi) << 16); }
__device__ __forceinline__ float bf2f(unsigned h) { return __uint_as_float(h << 16); }
__device__ __forceinline__ float bflo(unsigned w) { return __uint_as_float(w << 16); }
__device__ __forceinline__ float bfhi(unsigned w) { return __uint_as_float(w & 0xffff0000u); }
__device__ __forceinline__ float wave_sum(float v) {
#pragma unroll
    for (int o = 1; o < 64; o <<= 1) v += __shfl_xor(v, o);
    return v;
}
__device__ __forceinline__ float wave_max(float v) {
#pragma unroll
    for (int o = 1; o < 64; o <<= 1) v = fmaxf(v, __shfl_xor(v, o));
    return v;
}
__device__ __forceinline__ float sigmoidf_(float z) { return 1.0f / (1.0f + __expf(-z)); }
__device__ __forceinline__ float row16_sum(float v) {
    v += __builtin_bit_cast(float, __builtin_amdgcn_update_dpp(0, __builtin_bit_cast(int, v), 0xB1, 0xf, 0xf, false));
    v += __builtin_bit_cast(float, __builtin_amdgcn_update_dpp(0, __builtin_bit_cast(int, v), 0x4E, 0xf, 0xf, false));
    v += __builtin_bit_cast(float, __builtin_amdgcn_update_dpp(0, __builtin_bit_cast(int, v), 0x141, 0xf, 0xf, false));
    v += __builtin_bit_cast(float, __builtin_amdgcn_update_dpp(0, __builtin_bit_cast(int, v), 0x140, 0xf, 0xf, false));
    return v;
}

template <class Epi>
__device__ __forceinline__ void gemm_naive(unsigned char* lds, const bf16_t* A, const bf16_t* Bt, int M, int N, int K, const Epi& E, int bid, int nb) {
    float* As = (float*)lds;
    float* Bs = As + 32 * 132;
    const int tid = threadIdx.x, ty = tid >> 5, tx = tid & 31;
    const int lr = tid >> 2, ks = (tid & 3) * 8;
    const int ntn = N / 128, ntiles = (M / 128) * ntn;
    for (int tile = bid; tile < ntiles; tile += nb) {
        const int m0 = (tile / ntn) * 128, n0 = (tile % ntn) * 128;
        float acc[8][4];
#pragma unroll
        for (int i = 0; i < 8; ++i)
#pragma unroll
            for (int j = 0; j < 4; ++j) acc[i][j] = 0.f;
        for (int k0 = 0; k0 < K; k0 += 32) {
            const u32x4 av = *(const u32x4*)(A + (size_t)(m0 + lr) * K + k0 + ks);
            const u32x4 bv = *(const u32x4*)(Bt + (size_t)(n0 + lr) * K + k0 + ks);
            __syncthreads();
#pragma unroll
            for (int i = 0; i < 4; ++i) {
                As[(ks + 2 * i) * 132 + lr] = bflo(av[i]); As[(ks + 2 * i + 1) * 132 + lr] = bfhi(av[i]);
                Bs[(ks + 2 * i) * 132 + lr] = bflo(bv[i]); Bs[(ks + 2 * i + 1) * 132 + lr] = bfhi(bv[i]);
            }
            __syncthreads();
#pragma unroll 8
            for (int kk = 0; kk < 32; ++kk) {
                const f32x4 a0 = *(const f32x4*)&As[kk * 132 + ty * 8], a1 = *(const f32x4*)&As[kk * 132 + ty * 8 + 4];
                const f32x4 b = *(const f32x4*)&Bs[kk * 132 + tx * 4];
#pragma unroll
                for (int j = 0; j < 4; ++j) {
                    acc[0][j] += a0[0] * b[j]; acc[1][j] += a0[1] * b[j]; acc[2][j] += a0[2] * b[j]; acc[3][j] += a0[3] * b[j];
                    acc[4][j] += a1[0] * b[j]; acc[5][j] += a1[1] * b[j]; acc[6][j] += a1[2] * b[j]; acc[7][j] += a1[3] * b[j];
                }
            }
        }
#pragma unroll
        for (int i = 0; i < 8; ++i)
#pragma unroll
            for (int j = 0; j < 4; ++j) E(m0 + ty * 8 + i, n0 + tx * 4 + j, acc[i][j]);
    }
    __syncthreads();
}
struct NE_Split3 { bf16_t* base; size_t stride; __device__ __forceinline__ void operator()(int r, int c, float v) const { base[(size_t)(c >> 10) * stride + (size_t)r * 1024 + (c & 1023)] = (bf16_t)f2bf(v); } };
struct NE_F32 { float* out; int ld; __device__ __forceinline__ void operator()(int r, int c, float v) const { out[(size_t)r * ld + c] = v; } };
struct NE_Relu2 { bf16_t* out; int ld; __device__ __forceinline__ void operator()(int r, int c, float v) const { v = fmaxf(v, 0.f); out[(size_t)r * ld + c] = (bf16_t)f2bf(v * v); } };
struct NE_Bf16 { bf16_t* out; int ld; __device__ __forceinline__ void operator()(int r, int c, float v) const { out[(size_t)r * ld + c] = (bf16_t)f2bf(v); } };
__device__ __forceinline__ float low_fn(int c, float v, const float* w0, const float* a0) {
    if (c < 1024) {
        const float z = -(w0[c] + v);
        const float sp = fmaxf(z, 0.f) + log1pf(__expf(-fabsf(z)));
        const float e = __expf(-sp - 0.5f);
        return -expm1f(-e);
    } else if (c < 2048) {
        return sigmoidf_(a0[c - 1024] + v);
    }
    return v;
}
struct NE_Low { bf16_t* base; size_t stride; const float* w0; const float* a0;
    __device__ __forceinline__ void operator()(int r, int c, float v) const { base[(size_t)(c >> 10) * stride + (size_t)r * 1024 + (c & 1023)] = (bf16_t)f2bf(low_fn(c, v, w0, a0)); } };

__device__ __forceinline__ void p0_transpose_item(const float* W, int ldw, int K, int N, bf16_t* WT, float* scr, int item, int lane) {
    const int nblk = N / 32, kb = item / nblk, nbk = item % nblk, k0 = 64 * kb, n0 = 32 * nbk;
#pragma unroll 8
    for (int i = 0; i < 32; ++i) { const int kk = 2 * i + (lane >> 5); scr[kk * 33 + (lane & 31)] = W[(size_t)(k0 + kk) * ldw + n0 + (lane & 31)]; }
    asm volatile("s_waitcnt lgkmcnt(0)" ::: "memory");
    const int c = lane & 7;
#pragma unroll
    for (int j = 0; j < 4; ++j) { const int n = (lane >> 3) + 8 * j; const float* s = scr + (8 * c) * 33 + n;
        u32x4 o; o.x = pk2(s[0 * 33], s[1 * 33]); o.y = pk2(s[2 * 33], s[3 * 33]); o.z = pk2(s[4 * 33], s[5 * 33]); o.w = pk2(s[6 * 33], s[7 * 33]);
        *(u32x4*)(WT + (size_t)(n0 + n) * K + k0 + 8 * c) = o; }
    asm volatile("s_waitcnt lgkmcnt(0)" ::: "memory");
}
__device__ __forceinline__ void st_prologue(const Params& p, unsigned char* lds, int bid, int nb) {
    const int tid = threadIdx.x, lane = tid & 63, wid = tid >> 6;
    const int gw = bid * NWAVES + wid, NGW = nb * NWAVES;
    float* scr = (float*)(lds + wid * 16384);
    unsigned char* ws = p.ws;
    constexpr int I0 = 16 * 96, I1 = 16 * 32, I2 = 16 * 128, I3 = 64 * 32, I4 = 16 * 104, I5 = 16 * 32, I6 = 16 * 128, I7 = 64 * 32;
    constexpr int NIT = I0 + I1 + I2 + I3 + I4 + I5 + I6 + I7;
    for (int it = gw; it < NIT; it += NGW) {
        int r = it;
        if (r < I0) { p0_transpose_item(p.in[1], MPROJ, 1024, 3072, (bf16_t*)(ws + WS_WMIN), scr, r, lane); continue; } r -= I0;
        if (r < I1) { p0_transpose_item(p.in[7], 1024, 1024, 1024, (bf16_t*)(ws + WS_WMOUT), scr, r, lane); continue; } r -= I1;
        if (r < I2) { p0_transpose_item(p.in[23], 4096, 1024, 4096, (bf16_t*)(ws + WS_W1_0), scr, r, lane); continue; } r -= I2;
        if (r < I3) { p0_transpose_item(p.in[24], 1024, 4096, 1024, (bf16_t*)(ws + WS_W2_0), scr, r, lane); continue; } r -= I3;
        if (r < I4) { p0_transpose_item(p.in[8], RPROJ, 1024, 3328, (bf16_t*)(ws + WS_WRIN), scr, r, lane); continue; } r -= I4;
        if (r < I5) { p0_transpose_item(p.in[20], 1024, 1024, 1024, (bf16_t*)(ws + WS_WROUT), scr, r, lane); continue; } r -= I5;
        if (r < I6) { p0_transpose_item(p.in[23] + (size_t)1024 * 4096, 4096, 1024, 4096, (bf16_t*)(ws + WS_W1_1), scr, r, lane); continue; } r -= I6;
        p0_transpose_item(p.in[24] + (size_t)4096 * 1024, 1024, 4096, 1024, (bf16_t*)(ws + WS_W2_1), scr, r, lane);
    }
    {
        bf16_t* wl = (bf16_t*)(ws + WS_WLOW);
        const float* w2 = p.in[11]; const float* a2 = p.in[13]; const float* g2 = p.in[14];
        for (int idx = bid * NT + tid; idx < 3072 * 256; idx += nb * NT) {
            const int n = idx >> 8, k = idx & 255; float v = 0.f;
            if (n < 1024) { if (k < 64) v = w2[k * 1024 + n]; }
            else if (n < 2048) { if (k >= 64 && k < 128) v = a2[(k - 64) * 1024 + (n - 1024)]; }
            else { if (k >= 128) v = g2[(k - 128) * 1024 + (n - 2048)]; }
            wl[idx] = (bf16_t)f2bf(v);
        }
    }
    {
        const f32x4* x4 = (const f32x4*)p.in[0]; u32x2* xb = (u32x2*)(ws + WS_XB);
        for (int idx = bid * NT + tid; idx < T_ * D_ / 4; idx += nb * NT) { const f32x4 v = x4[idx]; u32x2 o; o.x = pk2(v[0], v[1]); o.y = pk2(v[2], v[3]); xb[idx] = o; }
    }
    {
        const float* x = p.in[0]; const float* win = p.in[1]; const float* b_i = p.in[2]; const float* b_f = p.in[3];
        float* LI = (float*)(ws + WS_LI); float* LF = (float*)(ws + WS_LF);
        for (int row = gw; row < T_; row += NGW) {
            float acc[8];
#pragma unroll
            for (int i = 0; i < 8; ++i) acc[i] = 0.f;
#pragma unroll
            for (int j = 0; j < 4; ++j) {
                const f32x4 xv = *(const f32x4*)(x + (size_t)row * 1024 + 4 * lane + 256 * j);
#pragma unroll
                for (int q = 0; q < 4; ++q) {
                    const float* wr = win + (size_t)(4 * lane + 256 * j + q) * MPROJ + 3072;
                    const f32x4 w0 = *(const f32x4*)wr, w1 = *(const f32x4*)(wr + 4); const float xs = xv[q];
                    acc[0] += xs * w0[0]; acc[1] += xs * w0[1]; acc[2] += xs * w0[2]; acc[3] += xs * w0[3];
                    acc[4] += xs * w1[0]; acc[5] += xs * w1[1]; acc[6] += xs * w1[2]; acc[7] += xs * w1[3];
                }
            }
            float pre = 0.f;
#pragma unroll
            for (int i = 0; i < 8; ++i) { const float s = wave_sum(acc[i]); if (lane == i) pre = s; }
            if (lane < 8) {
                const int b = row >> 12, t = row & 4095, h = lane & 3;
                if (lane < 4) { LI[(size_t)(b * 4 + h) * 4096 + t] = 15.0f * tanhf((pre + b_i[h]) * (1.0f / 15.0f)); }
                else { const float z = 15.0f * tanhf((pre + b_f[h]) * (1.0f / 15.0f)); LF[(size_t)(b * 4 + h) * 4096 + t] = fminf(z, 0.f) - log1pf(__expf(-fabsf(z))); }
            }
        }
    }
}

__device__ __forceinline__ void st_conv_gates(const Params& p, int bid, int nb) {
    const int tid = threadIdx.x, lane = tid & 63, wid = tid >> 6;
    unsigned char* ws = p.ws;
    const bf16_t* qr = (const bf16_t*)(ws + WS_QKRAW); bf16_t* qc = (bf16_t*)(ws + WS_QKC);
    const float* cw = p.in[4]; const float* cb = p.in[5];
    for (int idx = bid * NT + tid; idx < T_ * 128; idx += nb * NT) {
        const int row = idx >> 7, c0 = (idx & 127) * 8, t = row & 4095;
        float s[8];
#pragma unroll
        for (int i = 0; i < 8; ++i) s[i] = cb[c0 + i];
#pragma unroll
        for (int j = 0; j < 4; ++j) {
            if (t - 3 + j >= 0) {
                const u32x4 v = *(const u32x4*)(qr + (size_t)(row - 3 + j) * 1024 + c0);
                const f32x4 wa = *(const f32x4*)(cw + j * 1024 + c0), wb = *(const f32x4*)(cw + j * 1024 + c0 + 4);
                s[0] += wa[0] * bflo(v.x); s[1] += wa[1] * bfhi(v.x); s[2] += wa[2] * bflo(v.y); s[3] += wa[3] * bfhi(v.y);
                s[4] += wb[0] * bflo(v.z); s[5] += wb[1] * bfhi(v.z); s[6] += wb[2] * bflo(v.w); s[7] += wb[3] * bfhi(v.w);
            }
        }
        const float sc = (c0 < 512) ? 0.08838834764831845f : 1.0f;
#pragma unroll
        for (int i = 0; i < 8; ++i) s[i] = s[i] * sigmoidf_(s[i]) * sc;
        u32x4 o; o.x = pk2(s[0], s[1]); o.y = pk2(s[2], s[3]); o.z = pk2(s[4], s[5]); o.w = pk2(s[6], s[7]);
        *(u32x4*)(qc + (size_t)row * 1024 + c0) = o;
    }
    const float* LI = (const float*)(ws + WS_LI); const float* LF = (const float*)(ws + WS_LF);
    float* BC = (float*)(ws + WS_BC); float* GG = (float*)(ws + WS_GG);
    for (int u = bid * NWAVES + wid; u < 1024; u += nb * NWAVES) {
        float s = LF[u * 64 + lane];
#pragma unroll
        for (int o = 1; o < 64; o <<= 1) { const float t2 = __shfl_up(s, o); if (lane >= o) s += t2; }
        BC[u * 64 + lane] = s; GG[u * 64 + lane] = LI[u * 64 + lane] - s;
    }
}

constexpr int ML_QS = 0, ML_KS = 17408, ML_KWT = 34816, ML_VT = 53248, ML_PS = 57856, ML_CT = 67072, ML_VEC = 75776;
__device__ __forceinline__ void st_mlstm(const Params& p, unsigned char* lds, int bid, int nb) {
    const int tid = threadIdx.x, lane = tid & 63, wid = tid >> 6, fr = lane & 15, fq = lane >> 4;
    unsigned char* ws = p.ws;
    bf16_t* Qs = (bf16_t*)(lds + ML_QS); bf16_t* Ks = (bf16_t*)(lds + ML_KS); bf16_t* Kwt = (bf16_t*)(lds + ML_KWT);
    bf16_t* Vt = (bf16_t*)(lds + ML_VT); bf16_t* Ps = (bf16_t*)(lds + ML_PS); bf16_t* Ct = (bf16_t*)(lds + ML_CT);
    float* Mv = (float*)(lds + ML_VEC); float* GGv = Mv + 64; float* BCv = Mv + 128; float* den_s = Mv + 192;
    float* mprev_s = Mv + 256; float* Mlast_s = Mv + 320; float* gmax_s = Mv + 384; float* blast_s = Mv + 448;
    const bf16_t* QKC = (const bf16_t*)(ws + WS_QKC); const bf16_t* V0 = (const bf16_t*)(ws + WS_V0);
    const float* BC = (const float*)(ws + WS_BC); const float* GG = (const float*)(ws + WS_GG);
    float* HR = (float*)(ws + WS_HRAW);
    for (int unit = bid; unit < 256; unit += nb) {
        const int bh = unit >> 4, sl = unit & 15, b = bh >> 2, h = bh & 3;
        const int e0 = h * 256 + sl * 16;
        for (int c = wid; c < 64; c += 8) {
            const float g = GG[bh * 4096 + c * 64 + lane]; const float gm = wave_max(g);
            if (lane == 0) { gmax_s[c] = gm; blast_s[c] = BC[bh * 4096 + c * 64 + 63]; }
        }
        for (int i = tid; i < 32 * 136; i += NT) Ct[i] = 0;
        for (int i = tid; i < 32 * 72; i += NT) Vt[i] = (i >= 16 * 72 && i < 16 * 72 + 64) ? (bf16_t)0x3F80 : (bf16_t)0;
        __syncthreads();
        if (tid == 0) { float m = 0.f; for (int c = 0; c < 64; ++c) { mprev_s[c] = m; const float Ml = fmaxf(m, gmax_s[c]); Mlast_s[c] = Ml; m = blast_s[c] + Ml; } }
        f32x4 cacc[2]; cacc[0] = (f32x4){0.f, 0.f, 0.f, 0.f}; cacc[1] = cacc[0];
        __syncthreads();
        for (int c = 0; c < 64; ++c) {
            const int t0 = b * 4096 + c * 64;
            const float mprev = mprev_s[c], Mlast = Mlast_s[c];
#pragma unroll
            for (int i = 0; i < 2; ++i) {
                const int idx = tid + i * NT, row = idx >> 4, seg = idx & 15;
                *(u32x4*)(Qs + row * 136 + seg * 8) = *(const u32x4*)(QKC + (size_t)(t0 + row) * 1024 + h * 128 + seg * 8);
                *(u32x4*)(Ks + row * 136 + seg * 8) = *(const u32x4*)(QKC + (size_t)(t0 + row) * 1024 + 512 + h * 128 + seg * 8);
            }
            if (tid < 128) {
                const int row = tid >> 1, half = tid & 1;
                const u32x4 v = *(const u32x4*)(V0 + (size_t)(t0 + row) * 1024 + e0 + half * 8);
                bf16_t* d = Vt + (half * 8) * 72 + row;
                d[0 * 72] = (bf16_t)(v.x & 0xffff); d[1 * 72] = (bf16_t)(v.x >> 16); d[2 * 72] = (bf16_t)(v.y & 0xffff); d[3 * 72] = (bf16_t)(v.y >> 16);
                d[4 * 72] = (bf16_t)(v.z & 0xffff); d[5 * 72] = (bf16_t)(v.z >> 16); d[6 * 72] = (bf16_t)(v.w & 0xffff); d[7 * 72] = (bf16_t)(v.w >> 16);
            }
            if (tid < 64) {
                const float g = GG[bh * 4096 + c * 64 + tid]; float cm = g;
#pragma unroll
                for (int o = 1; o < 64; o <<= 1) { const float t2 = __shfl_up(cm, o); if (lane >= o) cm = fmaxf(cm, t2); }
                Mv[tid] = fmaxf(mprev, cm); GGv[tid] = g; BCv[tid] = BC[bh * 4096 + c * 64 + tid];
            }
            __syncthreads();
            {
                const int l = tid & 63, ds = tid >> 6;
                const float wk = __expf(GGv[l] - Mlast);
                const u32x4 k0 = *(const u32x4*)(Ks + l * 136 + ds * 16), k1 = *(const u32x4*)(Ks + l * 136 + ds * 16 + 8);
                bf16_t* d = Kwt + (ds * 16) * 72 + l;
                d[0 * 72] = (bf16_t)f2bf(wk * bflo(k0.x)); d[1 * 72] = (bf16_t)f2bf(wk * bfhi(k0.x)); d[2 * 72] = (bf16_t)f2bf(wk * bflo(k0.y)); d[3 * 72] = (bf16_t)f2bf(wk * bfhi(k0.y));
                d[4 * 72] = (bf16_t)f2bf(wk * bflo(k0.z)); d[5 * 72] = (bf16_t)f2bf(wk * bfhi(k0.z)); d[6 * 72] = (bf16_t)f2bf(wk * bflo(k0.w)); d[7 * 72] = (bf16_t)f2bf(wk * bfhi(k0.w));
                d[8 * 72] = (bf16_t)f2bf(wk * bflo(k1.x)); d[9 * 72] = (bf16_t)f2bf(wk * bfhi(k1.x)); d[10 * 72] = (bf16_t)f2bf(wk * bflo(k1.y)); d[11 * 72] = (bf16_t)f2bf(wk * bfhi(k1.y));
                d[12 * 72] = (bf16_t)f2bf(wk * bflo(k1.z)); d[13 * 72] = (bf16_t)f2bf(wk * bfhi(k1.z)); d[14 * 72] = (bf16_t)f2bf(wk * bflo(k1.w)); d[15 * 72] = (bf16_t)f2bf(wk * bfhi(k1.w));
            }
            {
                const int lt = wid & 3, sp = wid >> 2;
#pragma unroll
                for (int si = 0; si < 2; ++si) {
                    const int st = sp * 2 + si;
                    f32x4 acc = (f32x4){0.f, 0.f, 0.f, 0.f};
#pragma unroll
                    for (int kk = 0; kk < 4; ++kk) {
                        const bf16x8 a = *(const bf16x8*)(Qs + (lt * 16 + fr) * 136 + kk * 32 + fq * 8);
                        const bf16x8 bb = *(const bf16x8*)(Ks + (st * 16 + fr) * 136 + kk * 32 + fq * 8);
                        acc = __builtin_amdgcn_mfma_f32_16x16x32_bf16(a, bb, acc, 0, 0, 0);
                    }
                    const int s = st * 16 + fr; const float gs = GGv[s];
#pragma unroll
                    for (int j = 0; j < 4; ++j) {
                        const int l = lt * 16 + fq * 4 + j;
                        const float pv = (s <= l) ? acc[j] * __expf(fminf(gs - Mv[l], 0.f)) : 0.f;
                        Ps[l * 72 + s] = (bf16_t)f2bf(pv);
                    }
                }
            }
            __syncthreads();
            const int lt = wid & 3, et = wid >> 2;
            f32x4 acc = (f32x4){0.f, 0.f, 0.f, 0.f};
#pragma unroll
            for (int kk = 0; kk < 4; ++kk) {
                const bf16x8 a = *(const bf16x8*)(Qs + (lt * 16 + fr) * 136 + kk * 32 + fq * 8);
                const bf16x8 bb = *(const bf16x8*)(Ct + (et * 16 + fr) * 136 + kk * 32 + fq * 8);
                acc = __builtin_amdgcn_mfma_f32_16x16x32_bf16(a, bb, acc, 0, 0, 0);
            }
#pragma unroll
            for (int j = 0; j < 4; ++j) acc[j] *= __expf(mprev - Mv[lt * 16 + fq * 4 + j]);
#pragma unroll
            for (int kk = 0; kk < 2; ++kk) {
                const bf16x8 a = *(const bf16x8*)(Ps + (lt * 16 + fr) * 72 + kk * 32 + fq * 8);
                const bf16x8 bb = *(const bf16x8*)(Vt + (et * 16 + fr) * 72 + kk * 32 + fq * 8);
                acc = __builtin_amdgcn_mfma_f32_16x16x32_bf16(a, bb, acc, 0, 0, 0);
            }
            if (et == 1 && fr == 0) {
#pragma unroll
                for (int j = 0; j < 4; ++j) den_s[lt * 16 + fq * 4 + j] = acc[j];
            }
            {
                const float decay = __expf(mprev - Mlast);
#pragma unroll
                for (int e2 = 0; e2 < 2; ++e2) {
                    cacc[e2] = cacc[e2] * decay;
#pragma unroll
                    for (int kk = 0; kk < 2; ++kk) {
                        const bf16x8 a = *(const bf16x8*)(Kwt + (wid * 16 + fr) * 72 + kk * 32 + fq * 8);
                        const bf16x8 bb = *(const bf16x8*)(Vt + (e2 * 16 + fr) * 72 + kk * 32 + fq * 8);
                        cacc[e2] = __builtin_amdgcn_mfma_f32_16x16x32_bf16(a, bb, cacc[e2], 0, 0, 0);
                    }
                }
            }
            __syncthreads();
#pragma unroll
            for (int e2 = 0; e2 < 2; ++e2) {
                u32x2 o; o.x = pk2(cacc[e2][0], cacc[e2][1]); o.y = pk2(cacc[e2][2], cacc[e2][3]);
                *(u32x2*)(Ct + (e2 * 16 + fr) * 136 + wid * 16 + fq * 4) = o;
            }
            if (et == 0) {
#pragma unroll
                for (int j = 0; j < 4; ++j) {
                    const int l = lt * 16 + fq * 4 + j;
                    const float dn = fmaxf(fabsf(den_s[l]), __expf(-(BCv[l] + Mv[l])));
                    HR[(size_t)(t0 + l) * 1024 + e0 + fr] = acc[j] / dn;
                }
            }
            __syncthreads();
        }
    }
}

__device__ __forceinline__ void st_mnorm(const Params& p, int bid, int nb) {
    const int tid = threadIdx.x, lane = tid & 63, wid = tid >> 6;
    unsigned char* ws = p.ws;
    const float* HR = (const float*)(ws + WS_HRAW); const bf16_t* O0 = (const bf16_t*)(ws + WS_O0); bf16_t* HN = (bf16_t*)(ws + WS_HN);
    const float* ng = p.in[6];
    for (int u = bid * NWAVES + wid; u < T_ * 4; u += nb * NWAVES) {
        const int row = u >> 2, h = u & 3; const size_t off = (size_t)row * 1024 + h * 256 + lane * 4;
        const f32x4 v = *(const f32x4*)(HR + off);
        const float ss = wave_sum(v[0] * v[0] + v[1] * v[1] + v[2] * v[2] + v[3] * v[3]);
        const float rs = rsqrtf(ss * (1.0f / 256.0f) + 1e-6f);
        const u32x2 ov = *(const u32x2*)(O0 + off); const f32x4 g = *(const f32x4*)(ng + h * 256 + lane * 4);
        u32x2 o; o.x = pk2(v[0] * rs * g[0] * sigmoidf_(bflo(ov.x)), v[1] * rs * g[1] * sigmoidf_(bfhi(ov.x)));
        o.y = pk2(v[2] * rs * g[2] * sigmoidf_(bflo(ov.y)), v[3] * rs * g[3] * sigmoidf_(bfhi(ov.y)));
        *(u32x2*)(HN + off) = o;
    }
}

__device__ __forceinline__ void st_ln(const float* base, const float* tmp, float* out, bf16_t* outb, const float* g, const float* bt, int bid, int nb) {
    const int tid = threadIdx.x, lane = tid & 63, wid = tid >> 6;
    for (int row = bid * NWAVES + wid; row < T_; row += nb * NWAVES) {
        f32x4 v[4]; float s = 0.f;
#pragma unroll
        for (int j = 0; j < 4; ++j) { const size_t off = (size_t)row * 1024 + 4 * lane + 256 * j; v[j] = *(const f32x4*)(base + off) * DN_ALPHA + *(const f32x4*)(tmp + off); s += (v[j][0] + v[j][1]) + (v[j][2] + v[j][3]); }
        const float mean = wave_sum(s) * (1.0f / 1024.0f); float q = 0.f;
#pragma unroll
        for (int j = 0; j < 4; ++j) { v[j] = v[j] - mean; q += (v[j][0] * v[j][0] + v[j][1] * v[j][1]) + (v[j][2] * v[j][2] + v[j][3] * v[j][3]); }
        const float rstd = rsqrtf(wave_sum(q) * (1.0f / 1024.0f) + LN_EPS);
#pragma unroll
        for (int j = 0; j < 4; ++j) {
            const int c = 4 * lane + 256 * j; const size_t off = (size_t)row * 1024 + c;
            const f32x4 o = v[j] * rstd * *(const f32x4*)(g + c) + *(const f32x4*)(bt + c);
            *(f32x4*)(out + off) = o;
            if (outb) { u32x2 w; w.x = pk2(o[0], o[1]); w.y = pk2(o[2], o[3]); *(u32x2*)(outb + off) = w; }
        }
    }
}
__device__ __forceinline__ void st_cvt(const float* src, bf16_t* dst, int bid, int nb) {
    const f32x4* x4 = (const f32x4*)src; u32x2* xb = (u32x2*)dst;
    for (int idx = bid * NT + threadIdx.x; idx < T_ * D_ / 4; idx += nb * NT) { const f32x4 v = x4[idx]; u32x2 o; o.x = pk2(v[0], v[1]); o.y = pk2(v[2], v[3]); xb[idx] = o; }
}

__device__ __forceinline__ void st_lowa(const Params& p, int bid, int nb) {
    unsigned char* ws = p.ws;
    const bf16_t* PR = (const bf16_t*)(ws + WS_PR); bf16_t* LA = (bf16_t*)(ws + WS_LOWA); const float* mu = p.in[9];
    for (int idx = bid * NT + threadIdx.x; idx < T_ * 256; idx += nb * NT) {
        const int row = idx >> 8, j = idx & 255, t = row & 4095;
        const float cur = bf2f(PR[(size_t)row * RPROJ + 3072 + j]);
        const float prev = t > 0 ? bf2f(PR[(size_t)(row - 1) * RPROJ + 3072 + j]) : 0.f;
        const float v = cur + mu[3072 + j] * (prev - cur);
        const float o = j < 64 ? tanhf(v) : (j < 128 ? v : sigmoidf_(v));
        LA[idx] = (bf16_t)f2bf(o);
    }
}

constexpr int RW_TC = 32, RW_COOK_BYTES = RW_TC * 5 * 64 * 4, RW_VV = 2 * RW_COOK_BYTES, RW_YC = RW_VV + 2 * RW_TC * 16 * 4;
__device__ __forceinline__ bf16_t* y_ptr(unsigned char* ws, int row) { return row < 4096 ? (bf16_t*)(ws + WS_Y_B0) + (size_t)row * 1024 : (bf16_t*)(ws + WS_Y_B123) + (size_t)(row - 4096) * 1024; }
__device__ __forceinline__ void rwkv_cook(const Params& p, unsigned char* lds, int b, int h, int rs, int c, int ctid) {
    unsigned char* ws = p.ws;
    const bf16_t* PR = (const bf16_t*)(ws + WS_PR); const bf16_t* AA = (const bf16_t*)(ws + WS_A); const bf16_t* WM = (const bf16_t*)(ws + WS_W1M);
    const float* mu = p.in[9]; const float* k_k = p.in[15]; const float* k_a = p.in[16];
    float* cook = (float*)(lds + (c & 1) * RW_COOK_BYTES); float* VV = (float*)(lds + RW_VV) + (c & 1) * RW_TC * 16;
#pragma unroll
    for (int it = 0; it < 2; ++it) {
        const int item = ctid + it * 256, s = item >> 4, cgp = item & 15;
        const int t = c * RW_TC + s, row = b * 4096 + t, ch = h * 64 + 4 * cgp;
        const u32x2 rc = *(const u32x2*)(PR + (size_t)row * RPROJ + ch), kc = *(const u32x2*)(PR + (size_t)row * RPROJ + 1024 + ch);
        u32x2 rp = (u32x2){0u, 0u}, kp = rp; unsigned vp = 0;
        const unsigned vc = PR[(size_t)row * RPROJ + 2048 + h * 64 + rs * 16 + cgp];
        if (t > 0) { rp = *(const u32x2*)(PR + (size_t)(row - 1) * RPROJ + ch); kp = *(const u32x2*)(PR + (size_t)(row - 1) * RPROJ + 1024 + ch); vp = PR[(size_t)(row - 1) * RPROJ + 2048 + h * 64 + rs * 16 + cgp]; }
        const u32x2 av = *(const u32x2*)(AA + (size_t)row * 1024 + ch), wv = *(const u32x2*)(WM + (size_t)row * 1024 + ch);
        const f32x4 mur = *(const f32x4*)(mu + ch), muk = *(const f32x4*)(mu + 1024 + ch), kkw = *(const f32x4*)(k_k + ch), kaw = *(const f32x4*)(k_a + ch);
        f32x4 rcur = (f32x4){bflo(rc.x), bfhi(rc.x), bflo(rc.y), bfhi(rc.y)}, rprv = (f32x4){bflo(rp.x), bfhi(rp.x), bflo(rp.y), bfhi(rp.y)};
        f32x4 kcur = (f32x4){bflo(kc.x), bfhi(kc.x), bflo(kc.y), bfhi(kc.y)}, kprv = (f32x4){bflo(kp.x), bfhi(kp.x), bflo(kp.y), bfhi(kp.y)};
        const f32x4 a = (f32x4){bflo(av.x), bfhi(av.x), bflo(av.y), bfhi(av.y)}, w1m = (f32x4){bflo(wv.x), bfhi(wv.x), bflo(wv.y), bfhi(wv.y)};
        const f32x4 rl = rcur + mur * (rprv - rcur), kl = kcur + muk * (kprv - kcur);
        f32x4 kk = kl * kkw;
        float ss = kk[0] * kk[0] + kk[1] * kk[1] + kk[2] * kk[2] + kk[3] * kk[3];
        ss = row16_sum(ss);
        const float nrm = 1.0f / fmaxf(sqrtf(ss), 1e-12f);
        kk = kk * nrm;
        const f32x4 bb = kk * a, kpv = kl * (1.0f + (a - 1.0f) * kaw), w = 1.0f - w1m;
        float* cs = cook + s * 320 + 4 * cgp;
        *(f32x4*)(cs) = w; *(f32x4*)(cs + 64) = kk; *(f32x4*)(cs + 128) = bb; *(f32x4*)(cs + 192) = kpv; *(f32x4*)(cs + 256) = rl;
        const float vcur = bf2f(vc), vprv = bf2f(vp);
        VV[s * 16 + cgp] = vcur + mu[2048 + h * 64 + rs * 16 + cgp] * (vprv - vcur);
    }
}
__device__ __forceinline__ void st_rwkv_scan(const Params& p, unsigned char* lds, int bid, int nb) {
    const int tid = threadIdx.x, lane = tid & 63, wid = tid >> 6;
    unsigned char* ws = p.ws;
    float* Yc = (float*)(lds + RW_YC);
    for (int unit = bid; unit < 256; unit += nb) {
        const int bh = unit >> 2, rs = unit & 3, b = bh >> 4, h = bh & 15;
        __syncthreads();
        if (wid >= 4) rwkv_cook(p, lds, b, h, rs, 0, tid - 256);
        __syncthreads();
        f32x4 S = (f32x4){0.f, 0.f, 0.f, 0.f};
        const int rl = wid * 4 + (lane >> 4), cgp = lane & 15;
        for (int c = 0; c < SEQ_ / RW_TC; ++c) {
            if (wid >= 4) { if (c + 1 < SEQ_ / RW_TC) rwkv_cook(p, lds, b, h, rs, c + 1, tid - 256); }
            else {
                const float* cook = (const float*)(lds + (c & 1) * RW_COOK_BYTES); const float* VV = (const float*)(lds + RW_VV) + (c & 1) * RW_TC * 16;
#pragma unroll 4
                for (int s = 0; s < RW_TC; ++s) {
                    const float* cs = cook + s * 320 + 4 * cgp;
                    const f32x4 w = *(const f32x4*)(cs), kk = *(const f32x4*)(cs + 64), bb = *(const f32x4*)(cs + 128), kpv = *(const f32x4*)(cs + 192), r = *(const f32x4*)(cs + 256);
                    const float v = VV[s * 16 + rl];
                    const float sa = -row16_sum((S[0] * kk[0] + S[1] * kk[1]) + (S[2] * kk[2] + S[3] * kk[3]));
                    S = S * w + sa * bb + v * kpv;
                    const float y = row16_sum((S[0] * r[0] + S[1] * r[1]) + (S[2] * r[2] + S[3] * r[3]));
                    if (cgp == 0) Yc[s * 16 + rl] = y;
                }
            }
            __syncthreads();
            if (tid < 256) {
#pragma unroll
                for (int it = 0; it < 2; ++it) { const int item = tid + it * 256, s = item >> 4, r16 = item & 15; const int row = b * 4096 + c * RW_TC + s;
                    y_ptr(ws, row)[h * 64 + rs * 16 + r16] = (bf16_t)f2bf(Yc[item]); }
            }
            __syncthreads();
        }
    }
}

__device__ __forceinline__ void st_rwkv_post(const Params& p, int bid, int nb) {
    const int tid = threadIdx.x, lane = tid & 63, wid = tid >> 6;
    unsigned char* ws = p.ws;
    const bf16_t* PR = (const bf16_t*)(ws + WS_PR); const bf16_t* AA = (const bf16_t*)(ws + WS_A); const bf16_t* GB = (const bf16_t*)(ws + WS_G);
    bf16_t* YB = (bf16_t*)(ws + WS_YB);
    const float* mu = p.in[9]; const float* k_a = p.in[16]; const float* r_k = p.in[17]; const float* gn_g = p.in[18]; const float* gn_b = p.in[19];
    for (int u = bid * NWAVES + wid; u < T_ * 16; u += nb * NWAVES) {
        const int row = u >> 4, h = u & 15, t = row & 4095, ch = h * 64 + lane;
        const float y = bf2f(y_ptr(ws, row)[ch]);
        const float mean = wave_sum(y) * (1.0f / 64.0f); const float d = y - mean;
        const float var = wave_sum(d * d) * (1.0f / 64.0f);
        const float gn = d * rsqrtf(var + 64e-5f) * gn_g[ch] + gn_b[ch];
        const float rc = bf2f(PR[(size_t)row * RPROJ + ch]), kc = bf2f(PR[(size_t)row * RPROJ + 1024 + ch]), vc = bf2f(PR[(size_t)row * RPROJ + 2048 + ch]);
        float rp = 0.f, kp = 0.f, vp = 0.f;
        if (t > 0) { rp = bf2f(PR[(size_t)(row - 1) * RPROJ + ch]); kp = bf2f(PR[(size_t)(row - 1) * RPROJ + 1024 + ch]); vp = bf2f(PR[(size_t)(row - 1) * RPROJ + 2048 + ch]); }
        const float rl = rc + mu[ch] * (rp - rc), kl = kc + mu[1024 + ch] * (kp - kc), vl = vc + mu[2048 + ch] * (vp - vc);
        const float a = bf2f(AA[(size_t)row * 1024 + ch]);
        const float kpv = kl * (1.0f + (a - 1.0f) * k_a[ch]);
        const float rk = wave_sum(rl * kpv * r_k[ch]);
        const float o = (gn + rk * vl) * bf2f(GB[(size_t)row * 1024 + ch]);
        YB[(size_t)row * 1024 + ch] = (bf16_t)f2bf(o);
    }
}

constexpr int NPHASE = 21;
__global__ void __launch_bounds__(NT, 2) fwd_kernel(Params p) {
    extern __shared__ __attribute__((aligned(16))) unsigned char lds[];
    const int bid = blockIdx.x, nb = gridDim.x;
    unsigned char* ws = p.ws;
    const int lo = p.ph_lo, hi = p.ph_hi;
#define PH_SYNC(k) do { if ((k) + 1 < hi) cg::this_grid().sync(); } while (0)
    if (lo <= 0 && 0 < hi) { st_prologue(p, lds, bid, nb); PH_SYNC(0); }
    if (lo <= 1 && 1 < hi) { { NE_Split3 E{(bf16_t*)(ws + WS_QKRAW), (size_t)T_ * 1024}; gemm_naive(lds, (const bf16_t*)(ws + WS_XB), (const bf16_t*)(ws + WS_WMIN), T_, 3072, 1024, E, bid, nb); } PH_SYNC(1); }
    if (lo <= 2 && 2 < hi) { st_conv_gates(p, bid, nb); PH_SYNC(2); }
    if (lo <= 3 && 3 < hi) { st_mlstm(p, lds, bid, nb); PH_SYNC(3); }
    if (lo <= 4 && 4 < hi) { st_mnorm(p, bid, nb); PH_SYNC(4); }
    if (lo <= 5 && 5 < hi) { { NE_F32 E{(float*)(ws + WS_TMP_S3), 1024}; gemm_naive(lds, (const bf16_t*)(ws + WS_HN), (const bf16_t*)(ws + WS_WMOUT), T_, 1024, 1024, E, bid, nb); } PH_SYNC(5); }
    if (lo <= 6 && 6 < hi) { st_ln(p.in[0], (const float*)(ws + WS_TMP_S3), p.out, (bf16_t*)(ws + WS_XB), p.in[21], p.in[22], bid, nb); PH_SYNC(6); }
    if (lo <= 7 && 7 < hi) { { NE_Relu2 E{(bf16_t*)(ws + WS_HB), 4096}; gemm_naive(lds, (const bf16_t*)(ws + WS_XB), (const bf16_t*)(ws + WS_W1_0), T_, 4096, 1024, E, bid, nb); } PH_SYNC(7); }
    if (lo <= 8 && 8 < hi) { { NE_F32 E{(float*)(ws + WS_TMP_S5), 1024}; gemm_naive(lds, (const bf16_t*)(ws + WS_HB), (const bf16_t*)(ws + WS_W2_0), T_, 1024, 4096, E, bid, nb); } PH_SYNC(8); }
    if (lo <= 9 && 9 < hi) { st_ln(p.out, (const float*)(ws + WS_TMP_S5), p.out, nullptr, p.in[25], p.in[26], bid, nb); PH_SYNC(9); }
    if (lo <= 10 && 10 < hi) { st_cvt(p.out, (bf16_t*)(ws + WS_XB), bid, nb); PH_SYNC(10); }
    if (lo <= 11 && 11 < hi) { { NE_Bf16 E{(bf16_t*)(ws + WS_PR), RPROJ}; gemm_naive(lds, (const bf16_t*)(ws + WS_XB), (const bf16_t*)(ws + WS_WRIN), T_, RPROJ, 1024, E, bid, nb); } PH_SYNC(11); }
    if (lo <= 12 && 12 < hi) { st_lowa(p, bid, nb); PH_SYNC(12); }
    if (lo <= 13 && 13 < hi) { { NE_Low E{(bf16_t*)(ws + WS_W1M), (size_t)T_ * 1024, p.in[10], p.in[12]}; gemm_naive(lds, (const bf16_t*)(ws + WS_LOWA), (const bf16_t*)(ws + WS_WLOW), T_, 3072, 256, E, bid, nb); } PH_SYNC(13); }
    if (lo <= 14 && 14 < hi) { st_rwkv_scan(p, lds, bid, nb); PH_SYNC(14); }
    if (lo <= 15 && 15 < hi) { st_rwkv_post(p, bid, nb); PH_SYNC(15); }
    if (lo <= 16 && 16 < hi) { { NE_F32 E{(float*)(ws + WS_TMP_S8), 1024}; gemm_naive(lds, (const bf16_t*)(ws + WS_YB), (const bf16_t*)(ws + WS_WROUT), T_, 1024, 1024, E, bid, nb); } PH_SYNC(16); }
    if (lo <= 17 && 17 < hi) { st_ln(p.out, (const float*)(ws + WS_TMP_S8), p.out, (bf16_t*)(ws + WS_X3B), p.in[21] + 1024, p.in[22] + 1024, bid, nb); PH_SYNC(17); }
    if (lo <= 18 && 18 < hi) { { NE_Relu2 E{(bf16_t*)(ws + WS_HB), 4096}; gemm_naive(lds, (const bf16_t*)(ws + WS_X3B), (const bf16_t*)(ws + WS_W1_1), T_, 4096, 1024, E, bid, nb); } PH_SYNC(18); }
    if (lo <= 19 && 19 < hi) { { NE_F32 E{(float*)(ws + WS_TMP_S10), 1024}; gemm_naive(lds, (const bf16_t*)(ws + WS_HB), (const bf16_t*)(ws + WS_W2_1), T_, 1024, 4096, E, bid, nb); } PH_SYNC(19); }
    if (lo <= 20 && 20 < hi) { st_ln(p.out, (const float*)(ws + WS_TMP_S10), p.out, nullptr, p.in[25] + 1024, p.in[26] + 1024, bid, nb); PH_SYNC(20); }
#undef PH_SYNC
}

extern "C" void kernel_launch(void* const* d_in, const int* in_sizes, int n_in, void* d_out, int out_size, void* d_ws, size_t ws_size, hipStream_t stream) {
    static int grid = 0;
    if (grid == 0) {
        if (n_in != 27 || out_size != T_ * D_ || ws_size < WS_END) { fprintf(stderr, "kernel_launch: unexpected shapes (n_in %d out %d ws %zu)\n", n_in, out_size, ws_size); grid = -1; return; }
        int dev = 0, cus = 0, per_cu = 0;
        hipGetDevice(&dev); hipDeviceGetAttribute(&cus, hipDeviceAttributeMultiprocessorCount, dev);
        hipFuncSetAttribute((const void*)fwd_kernel, hipFuncAttributeMaxDynamicSharedMemorySize, LDS_BYTES);
        hipOccupancyMaxActiveBlocksPerMultiprocessor(&per_cu, (const void*)fwd_kernel, NT, LDS_BYTES);
        if (per_cu < 1) { fprintf(stderr, "kernel_launch: occupancy query says %d blocks/CU\n", per_cu); per_cu = 1; }
        grid = cus * per_cu;
        if (grid > 256) grid = 256;
        (void)hipGetLastError();
    }
    if (grid < 0) return;
    hipMemsetAsync((char*)d_ws + WS_CTL, 0, CTL_BYTES, stream);
    Params p{};
    for (int i = 0; i < 27; ++i) p.in[i] = (const float*)d_in[i];
    p.out = (float*)d_out; p.ws = (unsigned char*)d_ws;
#if N_LAUNCH_MODE == 1
    p.ph_lo = 0; p.ph_hi = NPHASE;
    void* args[] = {&p};
    hipError_t e = hipLaunchCooperativeKernel((const void*)fwd_kernel, dim3(grid), dim3(NT), args, LDS_BYTES, stream);
    if (e != hipSuccess) fprintf(stderr, "cooperative launch failed: %s (grid %d)\n", hipGetErrorString(e), grid);
#else
    for (int ph = 0; ph < NPHASE; ++ph) {
        p.ph_lo = ph; p.ph_hi = ph + 1;
        hipLaunchKernelGGL(fwd_kernel, dim3(grid), dim3(NT), LDS_BYTES, stream, p);
    }
#endif
}
```
